# Optimizing an MI355X kernel written in HIP

```python
import jax, jax.numpy as jnp
from jax import lax
import numpy as np

D_MODEL = 2048
BATCH = 4
SEQ = 4096
DEPTH = 1

D_MIX = D_MODEL
D_GMLP = D_MIX // 2
D_ATTN = D_MIX - D_GMLP
CHUNK = 128
GMLP_GROUPS = 8
GMLP_GROUP_DIM = D_GMLP // GMLP_GROUPS
HEAD_DIM = 64
N_Q_HEADS = D_ATTN // HEAD_DIM
N_KV_HEADS = 2
GQA_GROUP = N_Q_HEADS // N_KV_HEADS
D_KV = N_KV_HEADS * HEAD_DIM
WINDOW = 128
BLOCK = 128
ROPE_THETA = 10000.0
EPS = 1e-6

_SIZES = [D_GMLP, D_GMLP, D_GMLP, D_ATTN, D_KV, D_KV, D_ATTN]
_OFFS = list(np.cumsum(_SIZES)[:-1].tolist())
D_IN_PROJ = int(sum(_SIZES))
D_QKV = D_ATTN + 2 * D_KV
QKV_START = 3 * D_GMLP

kernel_name = "hybrid_gmlp_swa_sink_layer"


def rms_norm(x, g):
    xf = x.astype(jnp.float32)
    y = xf * lax.rsqrt(jnp.mean(xf * xf, axis=-1, keepdims=True) + EPS)
    return (y * g.astype(jnp.float32)).astype(x.dtype)


def layer_norm(x, g, b):
    xf = x.astype(jnp.float32)
    mu = jnp.mean(xf, axis=-1, keepdims=True)
    var = jnp.mean(jnp.square(xf - mu), axis=-1, keepdims=True)
    y = (xf - mu) * lax.rsqrt(var + EPS) * g.astype(jnp.float32) + b.astype(jnp.float32)
    return y.astype(x.dtype)


def rope(x, positions):
    half = HEAD_DIM // 2
    inv_freq = ROPE_THETA ** (-jnp.arange(half, dtype=jnp.float32) * (2.0 / HEAD_DIM))
    ang = positions.astype(jnp.float32)[..., None] * inv_freq
    cos = jnp.cos(ang)[:, :, None, :]
    sin = jnp.sin(ang)[:, :, None, :]
    xf = x.astype(jnp.float32)
    x1, x2 = xf[..., :half], xf[..., half:]
    return jnp.concatenate([x1 * cos - x2 * sin, x2 * cos + x1 * sin], axis=-1).astype(x.dtype)


def chunked_spatial_gating(u, v, ln_g, ln_b, w_s, b_s):
    B, S, _ = u.shape
    nc = S // CHUNK
    vn = layer_norm(v, ln_g, ln_b).reshape(B, nc, CHUNK, GMLP_GROUPS, GMLP_GROUP_DIM)
    causal = jnp.tril(jnp.ones((CHUNK, CHUNK), dtype=bool))
    w = w_s * causal.astype(w_s.dtype)
    mixed = jnp.einsum('gts,bnsgc->bntgc', w, vn)
    mixed = mixed + jnp.transpose(b_s)[None, None, :, :, None]
    return u * mixed.reshape(B, S, D_GMLP)


def sliding_window_attention(q, k, v, sinks):
    B, S, _, _ = q.shape
    nb = S // BLOCK
    qb = q.reshape(B, nb, BLOCK, N_KV_HEADS, GQA_GROUP, HEAD_DIM)
    kb = k.reshape(B, nb, BLOCK, N_KV_HEADS, HEAD_DIM)
    vb = v.reshape(B, nb, BLOCK, N_KV_HEADS, HEAD_DIM)
    pad = ((0, 0), (1, 0), (0, 0), (0, 0), (0, 0))
    kk = jnp.concatenate([jnp.pad(kb, pad)[:, :-1], kb], axis=2)
    vv = jnp.concatenate([jnp.pad(vb, pad)[:, :-1], vb], axis=2)
    scores = jnp.einsum('bnqhgd,bnkhd->bnhgqk', qb, kk,
                        preferred_element_type=jnp.float32) * (HEAD_DIM ** -0.5)
    qi = jnp.arange(BLOCK)[:, None] + BLOCK
    kj = jnp.arange(2 * BLOCK)[None, :]
    dist = qi - kj
    band = (dist >= 0) & (dist < WINDOW)
    blk = jnp.arange(nb)[:, None, None]
    valid = band[None] & ((blk * BLOCK + kj[None] - BLOCK) >= 0)
    scores = jnp.where(valid[None, :, None, None], scores, -jnp.inf)
    sink = sinks.astype(jnp.float32).reshape(N_KV_HEADS, GQA_GROUP)[None, None, :, :, None, None]
    m = jnp.maximum(jnp.max(scores, axis=-1, keepdims=True), sink)
    p = jnp.exp(scores - m)
    denom = jnp.sum(p, axis=-1, keepdims=True) + jnp.exp(sink - m)
    p = (p / denom).astype(v.dtype)
    out = jnp.einsum('bnhgqk,bnkhd->bnqhgd', p, vv)
    return out.reshape(B, S, N_Q_HEADS * HEAD_DIM)


def setup_inputs(seed: int = 0) -> dict:
    key = jax.random.key(seed)
    ks = jax.random.split(key, 12)
    f32 = jnp.float32
    x = jax.random.normal(ks[0], (BATCH, SEQ, D_MODEL), f32)
    offsets = jax.random.randint(ks[1], (BATCH, 1), 0, 1024, dtype=jnp.int32)
    positions = (jnp.arange(SEQ, dtype=jnp.int32)[None, :] + offsets).astype(jnp.int32)
    g_pre = 1.0 + 0.02 * jax.random.normal(ks[2], (DEPTH, D_MODEL), f32)
    w_in = jax.random.normal(ks[3], (DEPTH, D_MODEL, D_IN_PROJ), f32) * (D_MODEL ** -0.5)
    b_qkv = 0.01 * jax.random.normal(ks[4], (DEPTH, D_QKV), f32)
    ln_v_g = 1.0 + 0.02 * jax.random.normal(ks[5], (DEPTH, D_GMLP), f32)
    ln_v_b = 0.01 * jax.random.normal(ks[6], (DEPTH, D_GMLP), f32)
    w_spatial = jax.random.normal(ks[7], (DEPTH, GMLP_GROUPS, CHUNK, CHUNK), f32) * (CHUNK ** -0.5)
    b_spatial = 1.0 + 0.02 * jax.random.normal(ks[8], (DEPTH, GMLP_GROUPS, CHUNK), f32)
    attn_sinks = jax.random.normal(ks[9], (DEPTH, N_Q_HEADS), f32)
    w_out = jax.random.normal(ks[10], (DEPTH, D_MIX, D_MODEL), f32) * (D_MIX ** -0.5)
    g_post = 1.0 + 0.02 * jax.random.normal(ks[11], (DEPTH, D_MODEL), f32)
    return {"x": x, "positions": positions, "g_pre": g_pre, "w_in": w_in, "b_qkv": b_qkv,
            "ln_v_g": ln_v_g, "ln_v_b": ln_v_b, "w_spatial": w_spatial, "b_spatial": b_spatial,
            "attn_sinks": attn_sinks, "w_out": w_out, "g_post": g_post}


def reference(x, positions, g_pre, w_in, b_qkv, ln_v_g, ln_v_b, w_spatial, b_spatial,
              attn_sinks, w_out, g_post):
    B, S, _ = x.shape
    for l in range(DEPTH):
        h = rms_norm(x, g_pre[l])
        proj = jnp.einsum('bsd,de->bse', h, w_in[l])
        bias = jnp.concatenate([jnp.zeros((QKV_START,), proj.dtype), b_qkv[l].astype(proj.dtype),
                                jnp.zeros((D_ATTN,), proj.dtype)])
        proj = proj + bias
        u, v_g, z_a, q, k, v_a, z_b = jnp.split(proj, _OFFS, axis=-1)
        y_a = chunked_spatial_gating(u, v_g, ln_v_g[l], ln_v_b[l], w_spatial[l], b_spatial[l])
        y_a = y_a * jax.nn.silu(z_a)
        q = rope(q.reshape(B, S, N_Q_HEADS, HEAD_DIM), positions)
        k = rope(k.reshape(B, S, N_KV_HEADS, HEAD_DIM), positions)
        v_a = v_a.reshape(B, S, N_KV_HEADS, HEAD_DIM)
        y_b = sliding_window_attention(q, k, v_a, attn_sinks[l]) * jax.nn.silu(z_b)
        y = jnp.einsum('bse,ed->bsd', jnp.concatenate([y_a, y_b], axis=-1), w_out[l])
        x = x + rms_norm(y, g_post[l])
    return x
```

```cpp
#include <hip/hip_runtime.h>
#include <cmath>

constexpr int D_MODEL = 2048, BATCH = 4, SEQ = 4096, M = BATCH * SEQ;
constexpr int D_IN = 5376;
constexpr int OFF_U = 0, OFF_V = 1024, OFF_ZA = 2048, OFF_Q = 3072, OFF_K = 4096, OFF_VA = 4224, OFF_ZB = 4352;
constexpr float EPS = 1e-6f;

__device__ __forceinline__ float wave_sum(float v) {
#pragma unroll
    for (int o = 1; o < 64; o <<= 1) v += __shfl_xor(v, o);
    return v;
}
__device__ __forceinline__ float wave_max(float v) {
#pragma unroll
    for (int o = 1; o < 64; o <<= 1) v = fmaxf(v, __shfl_xor(v, o));
    return v;
}
__device__ __forceinline__ float silu(float z) { return z / (1.f + expf(-z)); }

__global__ void __launch_bounds__(256) k_rmsnorm_rows(const float* __restrict__ x, const float* __restrict__ g, float* __restrict__ h) {
    const int row = blockIdx.x * 4 + (threadIdx.x >> 6), lane = threadIdx.x & 63;
    const float4* xr = (const float4*)(x + (size_t)row * D_MODEL);
    const float4* gr = (const float4*)g;
    float4* hr = (float4*)(h + (size_t)row * D_MODEL);
    float4 v[8]; float s = 0.f;
#pragma unroll
    for (int j = 0; j < 8; ++j) { v[j] = xr[lane + 64 * j]; s += v[j].x * v[j].x + v[j].y * v[j].y + v[j].z * v[j].z + v[j].w * v[j].w; }
    s = wave_sum(s);
    const float r = 1.0f / sqrtf(s * (1.f / D_MODEL) + EPS);
#pragma unroll
    for (int j = 0; j < 8; ++j) { const float4 gg = gr[lane + 64 * j]; float4 o; o.x = v[j].x * r * gg.x; o.y = v[j].y * r * gg.y; o.z = v[j].z * r * gg.z; o.w = v[j].w * r * gg.w; hr[lane + 64 * j] = o; }
}

__global__ void __launch_bounds__(256) k_gemm_f32(const float* __restrict__ A, const float* __restrict__ B, float* __restrict__ C, int N, int K,
                                                  const float* __restrict__ bias, int blo, int bhi) {
    __shared__ float As[16][132];
    __shared__ float Bs[16][132];
    const int bm = blockIdx.y * 128, bn = blockIdx.x * 128;
    const int tid = threadIdx.x, tx = tid & 15, ty = tid >> 4;
    float acc[8][8];
#pragma unroll
    for (int i = 0; i < 8; ++i)
#pragma unroll
        for (int j = 0; j < 8; ++j) acc[i][j] = 0.f;
    for (int k0 = 0; k0 < K; k0 += 16) {
#pragma unroll
        for (int i = 0; i < 2; ++i) {
            const int idx = tid + 256 * i, r = idx >> 2, c4 = idx & 3;
            const float4 v = *(const float4*)(A + (size_t)(bm + r) * K + k0 + c4 * 4);
            As[c4 * 4 + 0][r] = v.x; As[c4 * 4 + 1][r] = v.y; As[c4 * 4 + 2][r] = v.z; As[c4 * 4 + 3][r] = v.w;
        }
#pragma unroll
        for (int i = 0; i < 2; ++i) {
            const int idx = tid + 256 * i, kk = idx >> 5, c4 = idx & 31;
            const float4 v = *(const float4*)(B + (size_t)(k0 + kk) * N + bn + c4 * 4);
            *(float4*)&Bs[kk][c4 * 4] = v;
        }
        __syncthreads();
#pragma unroll
        for (int kk = 0; kk < 16; ++kk) {
            float a[8], b[8];
            const float4 a0 = *(const float4*)&As[kk][ty * 8], a1 = *(const float4*)&As[kk][ty * 8 + 4];
            const float4 b0 = *(const float4*)&Bs[kk][tx * 8], b1 = *(const float4*)&Bs[kk][tx * 8 + 4];
            a[0] = a0.x; a[1] = a0.y; a[2] = a0.z; a[3] = a0.w; a[4] = a1.x; a[5] = a1.y; a[6] = a1.z; a[7] = a1.w;
            b[0] = b0.x; b[1] = b0.y; b[2] = b0.z; b[3] = b0.w; b[4] = b1.x; b[5] = b1.y; b[6] = b1.z; b[7] = b1.w;
#pragma unroll
            for (int i = 0; i < 8; ++i)
#pragma unroll
                for (int j = 0; j < 8; ++j) acc[i][j] = fmaf(a[i], b[j], acc[i][j]);
        }
        __syncthreads();
    }
    float bv[8];
#pragma unroll
    for (int j = 0; j < 8; ++j) { const int n = bn + tx * 8 + j; bv[j] = (bias != nullptr && n >= blo && n < bhi) ? bias[n - blo] : 0.f; }
#pragma unroll
    for (int i = 0; i < 8; ++i) {
        float* cp = C + (size_t)(bm + ty * 8 + i) * N + bn + tx * 8;
        float4 o0, o1;
        o0.x = acc[i][0] + bv[0]; o0.y = acc[i][1] + bv[1]; o0.z = acc[i][2] + bv[2]; o0.w = acc[i][3] + bv[3];
        o1.x = acc[i][4] + bv[4]; o1.y = acc[i][5] + bv[5]; o1.z = acc[i][6] + bv[6]; o1.w = acc[i][7] + bv[7];
        *(float4*)cp = o0; *(float4*)(cp + 4) = o1;
    }
}

__global__ void __launch_bounds__(256) k_ln_stats(const float* __restrict__ proj, float2* __restrict__ stats) {
    const int row = blockIdx.x * 4 + (threadIdx.x >> 6), lane = threadIdx.x & 63;
    const float4* vr = (const float4*)(proj + (size_t)row * D_IN + OFF_V);
    float4 v[4]; float s = 0.f;
#pragma unroll
    for (int j = 0; j < 4; ++j) { v[j] = vr[lane + 64 * j]; s += v[j].x + v[j].y + v[j].z + v[j].w; }
    const float mean = wave_sum(s) * (1.f / 1024.f);
    float q = 0.f;
#pragma unroll
    for (int j = 0; j < 4; ++j) { const float a = v[j].x - mean, b = v[j].y - mean, c = v[j].z - mean, d = v[j].w - mean; q += a * a + b * b + c * c + d * d; }
    const float var = wave_sum(q) * (1.f / 1024.f);
    if (lane == 0) stats[row] = make_float2(mean, 1.0f / sqrtf(var + EPS));
}

__global__ void __launch_bounds__(256) k_gmlp(const float* __restrict__ proj, const float2* __restrict__ stats, const float* __restrict__ ln_g, const float* __restrict__ ln_b,
                                              const float* __restrict__ w_sp, const float* __restrict__ b_sp, float* __restrict__ ycat) {
    __shared__ float vn[128][128];
    const int g = blockIdx.x & 7, nc = (blockIdx.x >> 3) & 31, b = blockIdx.x >> 8;
    const int row0 = b * SEQ + nc * 128;
    const int tid = threadIdx.x;
    for (int idx = tid; idx < 128 * 128; idx += 256) {
        const int s = idx >> 7, c = idx & 127;
        const float2 st = stats[row0 + s];
        vn[s][c] = (proj[(size_t)(row0 + s) * D_IN + OFF_V + g * 128 + c] - st.x) * st.y * ln_g[g * 128 + c] + ln_b[g * 128 + c];
    }
    __syncthreads();
    const int c = tid & 127, th = tid >> 7;
    for (int t = th * 64; t < th * 64 + 64; ++t) {
        const float* wr = w_sp + ((size_t)g * 128 + t) * 128;
        float acc = 0.f;
        for (int s = 0; s <= t; ++s) acc = fmaf(wr[s], vn[s][c], acc);
        acc += b_sp[g * 128 + t];
        const size_t pr = (size_t)(row0 + t) * D_IN;
        const float u = proj[pr + OFF_U + g * 128 + c], za = proj[pr + OFF_ZA + g * 128 + c];
        ycat[(size_t)(row0 + t) * D_MODEL + g * 128 + c] = u * acc * silu(za);
    }
}

__global__ void __launch_bounds__(256) k_rope(float* __restrict__ proj, const int* __restrict__ positions) {
    const long gid = (long)blockIdx.x * 256 + threadIdx.x;
    const int i = (int)(gid & 31), hh = (int)((gid >> 5) % 18), row = (int)(gid / (32 * 18));
    if (row >= M) return;
    const int base = hh < 16 ? OFF_Q + hh * 64 : OFF_K + (hh - 16) * 64;
    const float inv_freq = (float)pow(10000.0, -(double)i / 32.0);
    const float ang = (float)positions[row] * inv_freq;
    const float cs = (float)cos((double)ang), sn = (float)sin((double)ang);
    float* p = proj + (size_t)row * D_IN + base;
    const float x1 = p[i], x2 = p[i + 32];
    p[i] = x1 * cs - x2 * sn; p[i + 32] = x2 * cs + x1 * sn;
}

__global__ void __launch_bounds__(256) k_attn(const float* __restrict__ proj, const float* __restrict__ sinks, float* __restrict__ ycat) {
    __shared__ float qs[4][64];
    __shared__ float ps[4][128];
    const int w = threadIdx.x >> 6, lane = threadIdx.x & 63;
    const int pair = blockIdx.x * 4 + w, row = pair >> 4, head = pair & 15, kvh = head >> 3;
    const int b = row / SEQ, t = row % SEQ;
    qs[w][lane] = proj[(size_t)row * D_IN + OFF_Q + head * 64 + lane];
    __syncthreads();
    float sc[2];
#pragma unroll
    for (int h = 0; h < 2; ++h) {
        const int j = lane + 64 * h, p = t - 127 + j;
        float s = -INFINITY;
        if (p >= 0) {
            const float* kr = proj + (size_t)(b * SEQ + p) * D_IN + OFF_K + kvh * 64;
            float a = 0.f;
            for (int d = 0; d < 64; ++d) a = fmaf(qs[w][d], kr[d], a);
            s = a * 0.125f;
        }
        sc[h] = s;
    }
    const float sink = sinks[head];
    const float m = fmaxf(wave_max(fmaxf(sc[0], sc[1])), sink);
    const float p0 = expf(sc[0] - m), p1 = expf(sc[1] - m);
    const float denom = wave_sum(p0 + p1) + expf(sink - m);
    ps[w][lane] = p0 / denom; ps[w][lane + 64] = p1 / denom;
    __syncthreads();
    float o = 0.f;
    for (int j = 0; j < 128; ++j) {
        const int p = t - 127 + j;
        if (p >= 0) o = fmaf(ps[w][j], proj[(size_t)(b * SEQ + p) * D_IN + OFF_VA + kvh * 64 + lane], o);
    }
    const float zb = proj[(size_t)row * D_IN + OFF_ZB + head * 64 + lane];
    ycat[(size_t)row * D_MODEL + 1024 + head * 64 + lane] = o * silu(zb);
}

__global__ void __launch_bounds__(256) k_postnorm(const float* __restrict__ x, const float* __restrict__ g, float* __restrict__ out) {
    const int row = blockIdx.x * 4 + (threadIdx.x >> 6), lane = threadIdx.x & 63;
    const float4* xr = (const float4*)(x + (size_t)row * D_MODEL);
    const float4* gr = (const float4*)g;
    float4* yr = (float4*)(out + (size_t)row * D_MODEL);
    float4 v[8]; float s = 0.f;
#pragma unroll
    for (int j = 0; j < 8; ++j) { v[j] = yr[lane + 64 * j]; s += v[j].x * v[j].x + v[j].y * v[j].y + v[j].z * v[j].z + v[j].w * v[j].w; }
    s = wave_sum(s);
    const float r = 1.0f / sqrtf(s * (1.f / D_MODEL) + EPS);
#pragma unroll
    for (int j = 0; j < 8; ++j) { const float4 gg = gr[lane + 64 * j], xx = xr[lane + 64 * j]; float4 o;
        o.x = xx.x + v[j].x * r * gg.x; o.y = xx.y + v[j].y * r * gg.y; o.z = xx.z + v[j].z * r * gg.z; o.w = xx.w + v[j].w * r * gg.w; yr[lane + 64 * j] = o; }
}

extern "C" void kernel_launch(void* const* d_in, const int* in_sizes, int n_in, void* d_out, int out_size, void* d_ws, size_t ws_size, hipStream_t stream) {
    const float* x = (const float*)d_in[0]; const int* positions = (const int*)d_in[1]; const float* g_pre = (const float*)d_in[2];
    const float* w_in = (const float*)d_in[3]; const float* b_qkv = (const float*)d_in[4]; const float* ln_g = (const float*)d_in[5];
    const float* ln_b = (const float*)d_in[6]; const float* w_sp = (const float*)d_in[7]; const float* b_sp = (const float*)d_in[8];
    const float* sinks = (const float*)d_in[9]; const float* w_out = (const float*)d_in[10]; const float* g_post = (const float*)d_in[11];
    float* out = (float*)d_out;
    char* ws = (char*)d_ws;
    float* H = (float*)ws;
    float* PROJ = (float*)(ws + ((size_t)128 << 20));
    float2* STATS = (float2*)(ws + ((size_t)480 << 20));
    k_rmsnorm_rows<<<M / 4, 256, 0, stream>>>(x, g_pre, H);
    k_gemm_f32<<<dim3(D_IN / 128, M / 128), 256, 0, stream>>>(H, w_in, PROJ, D_IN, D_MODEL, b_qkv, OFF_Q, OFF_ZB);
    k_ln_stats<<<M / 4, 256, 0, stream>>>(PROJ, STATS);
    k_rope<<<(M * 18 * 32) / 256, 256, 0, stream>>>(PROJ, positions);
    k_gmlp<<<BATCH * 32 * 8, 256, 0, stream>>>(PROJ, STATS, ln_g, ln_b, w_sp, b_sp, H);
    k_attn<<<M * 16 / 4, 256, 0, stream>>>(PROJ, sinks, H);
    k_gemm_f32<<<dim3(D_MODEL / 128, M / 128), 256, 0, stream>>>(H, w_out, out, D_MODEL, D_MODEL, nullptr, 0, 0);
    k_postnorm<<<M / 4, 256, 0, stream>>>(x, g_post, out);
}
```

```cpp
#include <hip/hip_runtime.h>
#include <cstdio>
#include <cstdint>
#include <cmath>
constexpr int BATCH = 4, SEQ = 4096, DM = 2048, M = BATCH * SEQ, NPROJ = 5376;
constexpr int OFF_U = 0, OFF_V = 1024, OFF_ZA = 2048, OFF_Q = 3072, OFF_K = 4096, OFF_VA = 4224, OFF_ZB = 4352, QKV_START = 3072;
constexpr float LOG2E = 1.4426950408889634f, QSCALE = 0.125f * 1.4426950408889634f, NORM_EPS = 1e-6f;
__host__ __device__ constexpr int sigma32(int nb) {
    const int c = nb * 32, pn = c >> 8, w = c & 255, bj = w >> 7, wc = (w >> 5) & 3;
    if (pn < 8) return (bj ? OFF_ZA : OFF_U) + pn * 128 + wc * 32;
    if (pn < 12) return OFF_V + (pn - 8) * 256 + w;
    if (pn < 16) return OFF_Q + (pn - 12) * 256 + wc * 64 + bj * 32;
    if (pn == 16) return (wc < 2 ? OFF_K + wc * 64 : OFF_VA + (wc - 2) * 64) + bj * 32;
    return OFF_ZB + (pn - 17) * 256 + w;
}
#include <hip/hip_runtime.h>
#include <cstdio>
#include <cstdint>
namespace pg8 {
#define PG8_LAS __attribute__((address_space(3)))
typedef unsigned short bf16_t;
typedef short bf16x8 __attribute__((ext_vector_type(8)));
typedef float f32x4 __attribute__((ext_vector_type(4)));
typedef unsigned u32x4 __attribute__((ext_vector_type(4)));
constexpr int BM = 256, BK = 64, HALF = 128, HTB = HALF * BK * 2  , STAGE_BYTES = 8 * HTB, NXCD = 8, WGM = 8;

__host__ __device__ __forceinline__ int lds_byte(int r, int c) { const int st = (r >> 4) * 2 + (c >> 5), rr = r & 15, cc = c & 31, ob = rr * 64 + cc * 2; return st * 1024 + (ob ^ (((ob >> 9) & 1) << 5)); }
__host__ __device__ __forceinline__ void stage_rc(int b, int& R, int& C) { const int st = b / 1024, sb = b % 1024, swz = sb ^ (((sb >> 9) & 1) << 5); R = (st >> 1) * 16 + swz / 64; C = (st & 1) * 32 + (swz % 64) / 2; }
__host__ __device__ __forceinline__ int perm32(int rho) { const int n = rho >> 4, i = rho & 15; return 8 * (i >> 2) + 4 * n + (i & 3); }

struct Unit { int pm, pn; };
struct Gemm { const bf16_t* A; const bf16_t* Bt; int M, N, K; };

struct StaticOrder {
    int nM, nN, nwg, G, c;
    __host__ __device__ void init(int M, int N, int G_, int c_) { nM = M / BM; nN = N / BM; nwg = nM * nN; G = G_; c = c_; }
    __host__ __device__ bool next(int i, Unit& u) const {
        const long L = (long)i * G + c; if (L >= nwg) return false;
        int wgid = (int)L; { const int q = nwg / NXCD, r = nwg % NXCD, xcd = wgid % NXCD, off = wgid / NXCD; wgid = (xcd < r ? xcd * (q + 1) : r * (q + 1) + (xcd - r) * q) + off; }
        const int nig = WGM * nN, gid = wgid / nig, fm = gid * WGM, gsz = (nM - fm) < WGM ? (nM - fm) : WGM;
        u.pm = fm + ((wgid % nig) % gsz); u.pn = (wgid % nig) / gsz; return true;
    }
    __device__ __forceinline__ void a_ready(const Unit&) const {}
    __device__ __forceinline__ void done(const Unit&) const {}
};

__device__ __forceinline__ unsigned cvt_pk_bf16(float lo, float hi) { unsigned r; asm volatile("v_cvt_pk_bf16_f32 %0, %1, %2" : "=v"(r) : "v"(lo), "v"(hi)); return r; }
typedef float f32x2 __attribute__((ext_vector_type(2)));
__device__ __forceinline__ float silu_f(float z) { return z * __builtin_amdgcn_rcpf(1.0f + __builtin_amdgcn_exp2f(-1.4426950408889634f * z)); }
__device__ __forceinline__ u32x4 pack8(const f32x4 a, const f32x4 b) { u32x4 w; w.x = cvt_pk_bf16(a[0], a[1]); w.y = cvt_pk_bf16(a[2], a[3]); w.z = cvt_pk_bf16(b[0], b[1]); w.w = cvt_pk_bf16(b[2], b[3]); return w; }
struct EpiProj {
    static constexpr bool PERM = true, AFTER_DRAIN = false;
    bf16_t *UZ, *V, *Q, *K, *VA, *ZB; float* vstat; const float* bias; const float* cs;
    __device__ __forceinline__ void rope_store(const f32x4 (&acc)[2][2][4][2], int ai, int m, size_t row, int fq, const f32x4 (&b1)[2], const f32x4 (&b2)[2], float sc, bf16_t* dst) const {
        const float* cp = cs + row * 64 + fq * 8;
        const f32x4 c0 = *(const f32x4*)cp, c1 = *(const f32x4*)(cp + 4), s0 = *(const f32x4*)(cp + 32), s1 = *(const f32x4*)(cp + 36);
        const f32x4 x10 = acc[ai][0][m][0] + b1[0], x11 = acc[ai][0][m][1] + b1[1], x20 = acc[ai][1][m][0] + b2[0], x21 = acc[ai][1][m][1] + b2[1];
        const f32x4 o10 = (x10 * c0 - x20 * s0) * sc, o11 = (x11 * c1 - x21 * s1) * sc, o20 = (x20 * c0 + x10 * s0) * sc, o21 = (x21 * c1 + x11 * s1) * sc;
        *(u32x4*)dst = pack8(o10, o11); *(u32x4*)(dst + 32) = pack8(o20, o21);
    }
    __device__ __forceinline__ void operator()(const f32x4 (&acc)[2][2][4][2], const Unit& u, int wr, int wc, int fr, int fq) const {
        const int row0 = u.pm * BM + wr * 64 + fr, pn = u.pn;
        if (pn < 8) {
#pragma unroll
            for (int ai = 0; ai < 2; ++ai)
#pragma unroll
                for (int m = 0; m < 4; ++m) { const size_t row = (size_t)(row0 + ai * HALF + m * 16); f32x4 o0, o1;
#pragma unroll
                    for (int i = 0; i < 4; ++i) { o0[i] = acc[ai][0][m][0][i] * silu_f(acc[ai][1][m][0][i]); o1[i] = acc[ai][0][m][1][i] * silu_f(acc[ai][1][m][1][i]); }
                    *(u32x4*)(UZ + row * 1024 + pn * 128 + wc * 32 + fq * 8) = pack8(o0, o1); }
        } else if (pn < 12) {
#pragma unroll
            for (int ai = 0; ai < 2; ++ai)
#pragma unroll
                for (int m = 0; m < 4; ++m) { const size_t row = (size_t)(row0 + ai * HALF + m * 16); float s = 0.f, q = 0.f;
#pragma unroll
                    for (int bj = 0; bj < 2; ++bj) { const f32x4 v0 = acc[ai][bj][m][0], v1 = acc[ai][bj][m][1];
                        s += (v0[0] + v0[1]) + (v0[2] + v0[3]) + (v1[0] + v1[1]) + (v1[2] + v1[3]);
                        q += (v0[0] * v0[0] + v0[1] * v0[1]) + (v0[2] * v0[2] + v0[3] * v0[3]) + (v1[0] * v1[0] + v1[1] * v1[1]) + (v1[2] * v1[2] + v1[3] * v1[3]);
                        *(u32x4*)(V + row * 1024 + (pn - 8) * 256 + bj * HALF + wc * 32 + fq * 8) = pack8(v0, v1); }
                    s += __shfl_xor(s, 16); s += __shfl_xor(s, 32); q += __shfl_xor(q, 16); q += __shfl_xor(q, 32);
                    if (fq == 0) *(f32x2*)(vstat + (row * 16 + (pn - 8) * 4 + wc) * 2) = (f32x2){s, q}; }
        } else if (pn < 16) {
            const int head = (pn - 12) * 4 + wc; const float* bp = bias + (OFF_Q - QKV_START) + head * 64 + fq * 8;
            f32x4 b1[2], b2[2]; b1[0] = *(const f32x4*)bp; b1[1] = *(const f32x4*)(bp + 4); b2[0] = *(const f32x4*)(bp + 32); b2[1] = *(const f32x4*)(bp + 36);
#pragma unroll
            for (int ai = 0; ai < 2; ++ai)
#pragma unroll
                for (int m = 0; m < 4; ++m) { const size_t row = (size_t)(row0 + ai * HALF + m * 16); rope_store(acc, ai, m, row, fq, b1, b2, QSCALE, Q + row * 1024 + head * 64 + fq * 8); }
        } else if (pn == 16) {
            if (wc < 2) {
                const float* bp = bias + (OFF_K - QKV_START) + wc * 64 + fq * 8;
                f32x4 b1[2], b2[2]; b1[0] = *(const f32x4*)bp; b1[1] = *(const f32x4*)(bp + 4); b2[0] = *(const f32x4*)(bp + 32); b2[1] = *(const f32x4*)(bp + 36);
#pragma unroll
                for (int ai = 0; ai < 2; ++ai)
#pragma unroll
                    for (int m = 0; m < 4; ++m) { const size_t row = (size_t)(row0 + ai * HALF + m * 16); rope_store(acc, ai, m, row, fq, b1, b2, 1.0f, K + row * 128 + wc * 64 + fq * 8); }
            } else {
                const float* bp = bias + (OFF_VA - QKV_START) + (wc - 2) * 64 + fq * 8;
                f32x4 bb[2][2]; bb[0][0] = *(const f32x4*)bp; bb[0][1] = *(const f32x4*)(bp + 4); bb[1][0] = *(const f32x4*)(bp + 32); bb[1][1] = *(const f32x4*)(bp + 36);
#pragma unroll
                for (int ai = 0; ai < 2; ++ai)
#pragma unroll
                    for (int m = 0; m < 4; ++m) { const size_t row = (size_t)(row0 + ai * HALF + m * 16);
#pragma unroll
                        for (int bj = 0; bj < 2; ++bj) *(u32x4*)(VA + row * 128 + (wc - 2) * 64 + bj * 32 + fq * 8) = pack8(acc[ai][bj][m][0] + bb[bj][0], acc[ai][bj][m][1] + bb[bj][1]); }
            }
        } else {
#pragma unroll
            for (int ai = 0; ai < 2; ++ai)
#pragma unroll
                for (int m = 0; m < 4; ++m) { const size_t row = (size_t)(row0 + ai * HALF + m * 16);
#pragma unroll
                    for (int bj = 0; bj < 2; ++bj) { f32x4 o0, o1;
#pragma unroll
                        for (int i = 0; i < 4; ++i) { o0[i] = silu_f(acc[ai][bj][m][0][i]); o1[i] = silu_f(acc[ai][bj][m][1][i]); }
                        *(u32x4*)(ZB + row * 1024 + (pn - 17) * 256 + bj * HALF + wc * 32 + fq * 8) = pack8(o0, o1); } }
        }
    }
};
struct EpiOutF32 {
    static constexpr bool PERM = false, AFTER_DRAIN = false;
    float* C; float* ss;
    __device__ __forceinline__ void operator()(const f32x4 (&acc)[2][2][4][2], const Unit& u, int wr, int wc, int fr, int fq) const {
        const int row0 = u.pm * BM + wr * 64 + fr, col0 = u.pn * BM + wc * 32 + 4 * fq;
#pragma unroll
        for (int ai = 0; ai < 2; ++ai)
#pragma unroll
            for (int m = 0; m < 4; ++m) { const size_t row = (size_t)(row0 + ai * HALF + m * 16); float* rowp = C + row * 2048 + col0; float q = 0.f;
#pragma unroll
                for (int bj = 0; bj < 2; ++bj)
#pragma unroll
                    for (int n = 0; n < 2; ++n) { const f32x4 v = acc[ai][bj][m][n]; *(f32x4*)(rowp + bj * HALF + n * 16) = v; q += (v[0] * v[0] + v[1] * v[1]) + (v[2] * v[2] + v[3] * v[3]); }
                q += __shfl_xor(q, 16); q += __shfl_xor(q, 32);
                if (fq == 0) ss[row * 32 + u.pn * 4 + wc] = q; }
    }
};

template <class Epi, class Sched, bool ALIGN_EPI = false, bool SP2 = false>
__device__ __forceinline__ void gemm_phase(PG8_LAS unsigned char* lds, const Gemm g, const Sched& S, const Epi& E) {
    const int tid = threadIdx.x, wid = __builtin_amdgcn_readfirstlane(tid >> 6), lane = tid & 63, wr = wid >> 2, wc = wid & 3, fr = lane & 15, fq = lane >> 4;
    const int K = g.K, nt = K / BK;
    unsigned voffA[2], voffB[2];
#pragma unroll
    for (int i = 0; i < 2; ++i) { int R, C; stage_rc(tid * 16 + i * 8192, R, C); const int Rb = Epi::PERM ? ((R & ~31) + perm32(R & 31)) : R;
        voffA[i] = (unsigned)(R * K + C) * 2u; voffB[i] = (unsigned)(Rb * K + C) * 2u; }
    const size_t kstep = (size_t)(BK * 2);
    const size_t hstep = (size_t)HALF * K * 2;
    const size_t tstep = 2 * hstep;
    const unsigned ldsw = (unsigned)wid * 1024u;
    const int aoff = lds_byte(wr * 64 + fr, fq * 8), boff = lds_byte(wc * 32 + fr, fq * 8);
#define PG8_SA(b, h) (((b) * 2 + (h)) * HTB)
#define PG8_SB(b, h) ((4 + (b) * 2 + (h)) * HTB)
#define PG8_STAGE(bufoff, gbase, voff) do { _Pragma("unroll") for (int _i = 0; _i < 2; ++_i) \
        __builtin_amdgcn_global_load_lds((const unsigned*)((const char*)(gbase) + (voff)[_i]), (PG8_LAS unsigned*)(lds + (bufoff) + ldsw + _i * 8192), 16, 0, 0); } while (0)
#define PG8_LDA(dst, b, h) do { _Pragma("unroll") for (int m = 0; m < 4; ++m) _Pragma("unroll") for (int k = 0; k < 2; ++k) dst[m][k] = *(const PG8_LAS bf16x8*)(lds + PG8_SA(b, h) + aoff + m * 2048 + k * 1024); } while (0)
#define PG8_LDB(dst, b, h) do { _Pragma("unroll") for (int n = 0; n < 2; ++n) _Pragma("unroll") for (int k = 0; k < 2; ++k) dst[n][k] = *(const PG8_LAS bf16x8*)(lds + PG8_SB(b, h) + boff + n * 2048 + k * 1024); } while (0)
#define PG8_MMA(ai, bj, At, Bt) do { __builtin_amdgcn_s_setprio(1); _Pragma("unroll") for (int m = 0; m < 4; ++m) _Pragma("unroll") for (int n = 0; n < 2; ++n) _Pragma("unroll") for (int k = 0; k < 2; ++k) \
        acc[ai][bj][m][n] = __builtin_amdgcn_mfma_f32_16x16x32_bf16(Bt[n][k], At[m][k], acc[ai][bj][m][n], 0, 0, 0); __builtin_amdgcn_s_setprio(0); } while (0)
#define PG8_WAIT_V(n) asm volatile("s_waitcnt vmcnt(" #n ")" ::: "memory")
#define PG8_WAIT_L(n) asm volatile("s_waitcnt lgkmcnt(" #n ")" ::: "memory")
#define PG8_BAR __builtin_amdgcn_s_barrier()
#define PG8_SCHED __builtin_amdgcn_sched_barrier(0)
    Unit cur, nxt; int ui = 0;
    if (!S.next(0, cur)) return;
    f32x4 acc[2][2][4][2];
#pragma unroll
    for (int a = 0; a < 2; ++a)
#pragma unroll
        for (int b = 0; b < 2; ++b)
#pragma unroll
            for (int m = 0; m < 4; ++m)
#pragma unroll
                for (int n = 0; n < 2; ++n) acc[a][b][m][n] = (f32x4){0.f, 0.f, 0.f, 0.f};
    bf16x8 At[4][2], B0[2][2], B1[2][2];
    const char* cA = (const char*)g.A + (size_t)cur.pm * tstep; const char* cB = (const char*)g.Bt + (size_t)cur.pn * tstep;
    S.a_ready(cur);
    if constexpr (SP2) {
        PG8_STAGE(PG8_SB(0, 0), cB, voffB); PG8_STAGE(PG8_SB(0, 1), cB + hstep, voffB); PG8_STAGE(PG8_SA(0, 0), cA, voffA); PG8_STAGE(PG8_SA(0, 1), cA + hstep, voffA);
        if (wr == 1) PG8_BAR;
        PG8_WAIT_V(2); PG8_BAR;
        PG8_STAGE(PG8_SB(1, 0), cB + kstep, voffB); PG8_STAGE(PG8_SA(1, 0), cA + kstep, voffA); PG8_STAGE(PG8_SB(1, 1), cB + hstep + kstep, voffB);
        PG8_WAIT_V(6); PG8_BAR;
    } else {
        PG8_STAGE(PG8_SB(0, 0), cB, voffB); PG8_STAGE(PG8_SA(0, 0), cA, voffA); PG8_STAGE(PG8_SB(0, 1), cB + hstep, voffB); PG8_STAGE(PG8_SA(0, 1), cA + hstep, voffA);
        if (wr == 1) PG8_BAR;
        PG8_WAIT_V(4); PG8_BAR;
        PG8_STAGE(PG8_SB(1, 0), cB + kstep, voffB); PG8_STAGE(PG8_SA(1, 0), cA + kstep, voffA); PG8_STAGE(PG8_SB(1, 1), cB + hstep + kstep, voffB);
        PG8_WAIT_V(6); PG8_BAR;
    }
    for (;;) {
        const bool has_next = S.next(ui + 1, nxt);
        const char* nA = has_next ? (const char*)g.A + (size_t)nxt.pm * tstep : cA; const char* nB = has_next ? (const char*)g.Bt + (size_t)nxt.pn * tstep : cB;
        for (int t = 0; t < nt; t += 2) {
            const bool last = (t == nt - 2);
            const char* a1 = cA + (size_t)(t + 1) * kstep;
            const char* a2 = last ? nA : cA + (size_t)(t + 2) * kstep; const char* b2 = last ? nB : cB + (size_t)(t + 2) * kstep;
            const char* a3 = a2 + kstep; const char* b3 = b2 + kstep;
            if (last && has_next) S.a_ready(nxt);
            if constexpr (SP2) {
            PG8_LDB(B0, 0, 0); PG8_LDB(B1, 0, 1); PG8_SCHED; PG8_LDA(At, 0, 0); PG8_STAGE(PG8_SA(1, 1), a1 + hstep, voffA);
            PG8_WAIT_V(8); PG8_WAIT_L(0); PG8_BAR; PG8_MMA(0, 0, At, B0); PG8_MMA(0, 1, At, B1); PG8_BAR; PG8_SCHED;
            PG8_LDA(At, 0, 1); PG8_STAGE(PG8_SB(0, 0), b2, voffB); PG8_STAGE(PG8_SB(0, 1), b2 + hstep, voffB); PG8_STAGE(PG8_SA(0, 0), a2, voffA);
            PG8_WAIT_V(8); PG8_WAIT_L(0); PG8_BAR; PG8_MMA(1, 0, At, B0); PG8_MMA(1, 1, At, B1); PG8_BAR; PG8_SCHED;
            PG8_LDB(B0, 1, 0); PG8_LDB(B1, 1, 1); PG8_SCHED; PG8_LDA(At, 1, 0); PG8_STAGE(PG8_SA(0, 1), a2 + hstep, voffA);
            PG8_WAIT_V(8); PG8_WAIT_L(0); PG8_BAR; PG8_MMA(0, 0, At, B0); PG8_MMA(0, 1, At, B1); PG8_BAR; PG8_SCHED;
            PG8_LDA(At, 1, 1); PG8_STAGE(PG8_SB(1, 0), b3, voffB); PG8_STAGE(PG8_SB(1, 1), b3 + hstep, voffB); PG8_STAGE(PG8_SA(1, 0), a3, voffA);
            PG8_WAIT_V(8); PG8_WAIT_L(0); PG8_BAR; PG8_MMA(1, 0, At, B0); PG8_MMA(1, 1, At, B1); PG8_BAR; PG8_SCHED;
            } else {
            PG8_LDB(B0, 0, 0); PG8_SCHED; PG8_LDA(At, 0, 0); PG8_STAGE(PG8_SA(1, 1), a1 + hstep, voffA);
            PG8_WAIT_L(8); PG8_BAR; PG8_WAIT_L(0); PG8_MMA(0, 0, At, B0); PG8_BAR; PG8_SCHED;
            PG8_LDB(B1, 0, 1); PG8_STAGE(PG8_SB(0, 0), b2, voffB);
            PG8_BAR; PG8_WAIT_L(0); PG8_MMA(0, 1, At, B1); PG8_BAR;
            PG8_LDA(At, 0, 1); PG8_STAGE(PG8_SA(0, 0), a2, voffA);
            PG8_BAR; PG8_WAIT_L(0); PG8_MMA(1, 0, At, B0); PG8_BAR; PG8_SCHED;
            PG8_STAGE(PG8_SB(0, 1), b2 + hstep, voffB);
            PG8_WAIT_V(6); PG8_BAR; PG8_MMA(1, 1, At, B1); PG8_BAR;
            PG8_LDB(B0, 1, 0); PG8_SCHED; PG8_LDA(At, 1, 0); PG8_STAGE(PG8_SA(0, 1), a2 + hstep, voffA);
            PG8_WAIT_L(8); PG8_BAR; PG8_WAIT_L(0); PG8_MMA(0, 0, At, B0); PG8_BAR; PG8_SCHED;
            PG8_LDB(B1, 1, 1); PG8_STAGE(PG8_SB(1, 0), b3, voffB);
            PG8_BAR; PG8_WAIT_L(0); PG8_MMA(0, 1, At, B1); PG8_BAR;
            PG8_LDA(At, 1, 1); PG8_STAGE(PG8_SA(1, 0), a3, voffA);
            PG8_BAR; PG8_WAIT_L(0); PG8_MMA(1, 0, At, B0); PG8_BAR; PG8_SCHED;
            PG8_STAGE(PG8_SB(1, 1), b3 + hstep, voffB);
            PG8_WAIT_V(6); PG8_BAR; PG8_MMA(1, 1, At, B1); PG8_BAR;
            }
        }
        if constexpr (ALIGN_EPI) { if (wr == 0) PG8_BAR; }
        if constexpr (!Epi::AFTER_DRAIN) { E(acc, cur, wr, wc, fr, fq); S.done(cur); }
        if (!has_next) break;
#pragma unroll
        for (int a = 0; a < 2; ++a)
#pragma unroll
            for (int b = 0; b < 2; ++b)
#pragma unroll
                for (int m = 0; m < 4; ++m)
#pragma unroll
                    for (int n = 0; n < 2; ++n) acc[a][b][m][n] = (f32x4){0.f, 0.f, 0.f, 0.f};
        cur = nxt; cA = nA; cB = nB; ++ui;
        if constexpr (ALIGN_EPI) { if (wr == 1) PG8_BAR; }
    }
    PG8_WAIT_V(0);
    if constexpr (!ALIGN_EPI) { if (wr == 0) PG8_BAR; }
    PG8_BAR;
    if constexpr (Epi::AFTER_DRAIN) { E.fused(acc, cur, wr, wc, fr, fq, lds, wid, lane); S.done(cur); }
#undef PG8_SA
#undef PG8_SB
#undef PG8_STAGE
#undef PG8_LDA
#undef PG8_LDB
#undef PG8_MMA
#undef PG8_WAIT_V
#undef PG8_WAIT_L
#undef PG8_BAR
#undef PG8_SCHED
}
}

#ifndef PG8_SP2
#define PG8_SP2 true
#endif
#ifndef PG8_ALIGN
#define PG8_ALIGN true
#endif
namespace mix {
#define MLAS __attribute__((address_space(3)))
typedef unsigned short bf16_t;
typedef short bf16x8 __attribute__((ext_vector_type(8)));
typedef short s16x4 __attribute__((ext_vector_type(4)));
typedef short v4i16_t __attribute__((ext_vector_type(4)));
typedef float f32x16 __attribute__((ext_vector_type(16)));
typedef float f32x4 __attribute__((ext_vector_type(4)));
typedef float f32x2 __attribute__((ext_vector_type(2)));
typedef unsigned u32x4 __attribute__((ext_vector_type(4)));
typedef unsigned u32x2 __attribute__((ext_vector_type(2)));
typedef __bf16 bf16x2_t __attribute__((ext_vector_type(2)));
__device__ __forceinline__ unsigned cvtpk(float lo, float hi) { f32x2 v = {lo, hi}; bf16x2_t b = __builtin_convertvector(v, bf16x2_t); return __builtin_bit_cast(unsigned, b); }
__device__ __forceinline__ float bflo(unsigned w) { return __uint_as_float(w << 16); }
__device__ __forceinline__ float bfhi(unsigned w) { return __uint_as_float(w & 0xffff0000u); }
__device__ __forceinline__ s16x4 vtr(const MLAS unsigned char* p) { return __builtin_bit_cast(s16x4, __builtin_amdgcn_ds_read_tr16_b64_v4i16((MLAS v4i16_t*)p)); }
__device__ __forceinline__ bf16x8 cat8(s16x4 lo, s16x4 hi) { return (bf16x8){lo[0], lo[1], lo[2], lo[3], hi[0], hi[1], hi[2], hi[3]}; }
struct MixT { const bf16_t *UZ, *V, *Q, *K, *VA, *ZB; bf16_t* Y; const float* vstat; const float *ln_g, *ln_b, *w_sp, *b_sp, *sinks; };
constexpr int SEQ_ = 4096;
constexpr int K_CH = 256 * 16 + 16;
constexpr int LDS_KIMG = 0, LDS_VIMG = 33024;
constexpr int LDS_VN = 0, LDS_ST = 32768;

__device__ __forceinline__ void attn_item(const MixT& T, int b, int kvh, int qb, MLAS unsigned char* lds) {
    const int tid = threadIdx.x, lane = tid & 63, r32 = lane & 31, hi = lane >> 5; const int wid = __builtin_amdgcn_readfirstlane(tid >> 6);
    const long rowbase = (long)b * SEQ_ + (long)(qb - 1) * 128;
#pragma unroll
    for (int i = 0; i < 4; ++i) {
        const int id = tid + 512 * i, key = id >> 3, c = id & 7;
        u32x4 kv = (u32x4){0u, 0u, 0u, 0u}, vv = (u32x4){0u, 0u, 0u, 0u};
        if (qb > 0 || key >= 128) { const long r = rowbase + key; kv = *(const u32x4*)(T.K + r * 128 + kvh * 64 + c * 8); vv = *(const u32x4*)(T.VA + r * 128 + kvh * 64 + c * 8); }
        *(MLAS u32x4*)(lds + LDS_KIMG + c * K_CH + key * 16) = kv;
        *(MLAS u32x4*)(lds + LDS_VIMG + (c >> 2) * 16384 + key * 64 + (c & 3) * 16) = vv;
    }
    __syncthreads();
    const int head = kvh * 8 + wid;
    const float sink2 = T.sinks[head] * 1.4426950408889634f;
    const long q0 = (long)b * SEQ_ + (long)qb * 128;
    const MLAS unsigned char* kbase = lds + LDS_KIMG + hi * K_CH + r32 * 16;
    const MLAS unsigned char* vbase = lds + LDS_VIMG + (4 * hi + ((lane & 15) >> 2)) * 64 + ((lane >> 4) & 1) * 32 + (lane & 3) * 8;
    for (int qt = 0; qt < 4; ++qt) {
        const long row = q0 + qt * 32 + r32;
        bf16x8 qf[4];
#pragma unroll
        for (int s = 0; s < 4; ++s) qf[s] = *(const bf16x8*)(T.Q + row * 1024 + head * 64 + 16 * s + 8 * hi);
        f32x16 S[5];
#pragma unroll
        for (int j = 0; j < 5; ++j) {
            f32x16 a;
#pragma unroll
            for (int r = 0; r < 16; ++r) a[r] = 0.f;
#pragma unroll
            for (int s = 0; s < 4; ++s) { const bf16x8 kf = *(const MLAS bf16x8*)(kbase + (2 * s) * K_CH + ((qt + j) * 32) * 16); a = __builtin_amdgcn_mfma_f32_32x32x16_bf16(kf, qf[s], a, 0, 0, 0); }
            S[j] = a;
        }
        float mx = sink2;
#pragma unroll
        for (int j = 0; j < 5; ++j) {
            const bool dead = (qb == 0) && (qt + j < 4);
#pragma unroll
            for (int r = 0; r < 16; ++r) {
                const int krow = (r & 3) + 8 * (r >> 2) + 4 * hi;
                bool ok = !dead;
                if (j == 0) ok = ok && (krow > r32);
                if (j == 4) ok = ok && (krow <= r32);
                const float v = ok ? S[j][r] : -INFINITY;
                S[j][r] = v; mx = fmaxf(mx, v);
            }
        }
        mx = fmaxf(mx, __shfl_xor(mx, 32));
        float sum = 0.f;
#pragma unroll
        for (int j = 0; j < 5; ++j)
#pragma unroll
            for (int r = 0; r < 16; ++r) { const float p = __builtin_amdgcn_exp2f(S[j][r] - mx); S[j][r] = p; sum += p; }
        sum += __shfl_xor(sum, 32);
        const float inv = 1.0f / (sum + __builtin_amdgcn_exp2f(sink2 - mx));
        f32x16 O[2];
#pragma unroll
        for (int r = 0; r < 16; ++r) { O[0][r] = 0.f; O[1][r] = 0.f; }
#pragma unroll
        for (int j = 0; j < 5; ++j)
#pragma unroll
            for (int s2 = 0; s2 < 2; ++s2) {
                u32x4 pw; pw.x = cvtpk(S[j][8 * s2 + 0], S[j][8 * s2 + 1]); pw.y = cvtpk(S[j][8 * s2 + 2], S[j][8 * s2 + 3]); pw.z = cvtpk(S[j][8 * s2 + 4], S[j][8 * s2 + 5]); pw.w = cvtpk(S[j][8 * s2 + 6], S[j][8 * s2 + 7]);
                const bf16x8 pf = __builtin_bit_cast(bf16x8, pw);
#pragma unroll
                for (int dh = 0; dh < 2; ++dh) {
                    const MLAS unsigned char* vp = vbase + dh * 16384 + ((qt + j) * 32 + 16 * s2) * 64;
                    const s16x4 lo = vtr(vp), hi4 = vtr(vp + 8 * 64);
                    O[dh] = __builtin_amdgcn_mfma_f32_32x32x16_bf16(cat8(lo, hi4), pf, O[dh], 0, 0, 0);
                }
            }
        const bf16_t* zp = T.ZB + row * 1024 + head * 64; bf16_t* yp = T.Y + row * 2048 + 1024 + head * 64;
#pragma unroll
        for (int dh = 0; dh < 2; ++dh)
#pragma unroll
            for (int rq = 0; rq < 4; ++rq) {
                const int d0 = 32 * dh + 8 * rq + 4 * hi;
                const u32x2 z = *(const u32x2*)(zp + d0);
                u32x2 o; o.x = cvtpk(O[dh][4 * rq + 0] * inv * bflo(z.x), O[dh][4 * rq + 1] * inv * bfhi(z.x)); o.y = cvtpk(O[dh][4 * rq + 2] * inv * bflo(z.y), O[dh][4 * rq + 3] * inv * bfhi(z.y));
                *(u32x2*)(yp + d0) = o;
            }
    }
    __syncthreads();
}

__device__ __forceinline__ void gmlp_item(const MixT& T, int b, int nc, int g, MLAS unsigned char* lds) {
    const int tid = threadIdx.x, lane = tid & 63, r32 = lane & 31, hi = lane >> 5; const int wid = __builtin_amdgcn_readfirstlane(tid >> 6);
    const long row0 = (long)b * SEQ_ + (long)nc * 128;
    MLAS f32x2* st = (MLAS f32x2*)(lds + LDS_ST);
    if (tid < 128) {
        const f32x4* p = (const f32x4*)(T.vstat + (row0 + tid) * 32); float s = 0.f, q = 0.f;
#pragma unroll
        for (int k = 0; k < 8; ++k) { const f32x4 v = p[k]; s += v[0] + v[2]; q += v[1] + v[3]; }
        const float mean = s * (1.0f / 1024.0f), var = q * (1.0f / 1024.0f) - mean * mean;
        st[tid] = (f32x2){mean, 1.0f / sqrtf(fmaxf(var, 0.f) + 1e-6f)};
    }
    __syncthreads();
#pragma unroll
    for (int i = 0; i < 4; ++i) {
        const int id = tid + 512 * i, s = id >> 4, c8 = id & 15;
        const u32x4 raw = *(const u32x4*)(T.V + (row0 + s) * 1024 + g * 128 + c8 * 8);
        const f32x2 ms = st[s];
        const f32x4 g0 = *(const f32x4*)(T.ln_g + g * 128 + c8 * 8), g1 = *(const f32x4*)(T.ln_g + g * 128 + c8 * 8 + 4);
        const f32x4 b0 = *(const f32x4*)(T.ln_b + g * 128 + c8 * 8), b1 = *(const f32x4*)(T.ln_b + g * 128 + c8 * 8 + 4);
        u32x4 o;
        o.x = cvtpk((bflo(raw.x) - ms.x) * ms.y * g0[0] + b0[0], (bfhi(raw.x) - ms.x) * ms.y * g0[1] + b0[1]);
        o.y = cvtpk((bflo(raw.y) - ms.x) * ms.y * g0[2] + b0[2], (bfhi(raw.y) - ms.x) * ms.y * g0[3] + b0[3]);
        o.z = cvtpk((bflo(raw.z) - ms.x) * ms.y * g1[0] + b1[0], (bfhi(raw.z) - ms.x) * ms.y * g1[1] + b1[1]);
        o.w = cvtpk((bflo(raw.w) - ms.x) * ms.y * g1[2] + b1[2], (bfhi(raw.w) - ms.x) * ms.y * g1[3] + b1[3]);
        *(MLAS u32x4*)(lds + LDS_VN + (c8 >> 2) * 8192 + s * 64 + (c8 & 3) * 16) = o;
    }
    __syncthreads();
    const int tb = wid >> 1, cb0 = 2 * (wid & 1), t = tb * 32 + r32;
    const float* wrow = T.w_sp + ((long)g * 128 + t) * 128;
    f32x16 acc[2];
#pragma unroll
    for (int r = 0; r < 16; ++r) { acc[0][r] = 0.f; acc[1][r] = 0.f; }
    const MLAS unsigned char* vbase = lds + LDS_VN + (8 * hi + ((lane & 15) >> 2)) * 64 + ((lane >> 4) & 1) * 32 + (lane & 3) * 8;
    const int nks = 2 * (tb + 1);
    for (int ks = 0; ks < nks; ++ks) {
        const int s0 = ks * 16 + 8 * hi;
        const f32x4 w0 = *(const f32x4*)(wrow + s0), w1 = *(const f32x4*)(wrow + s0 + 4);
        u32x4 pw;
        pw.x = cvtpk(s0 + 0 <= t ? w0[0] : 0.f, s0 + 1 <= t ? w0[1] : 0.f); pw.y = cvtpk(s0 + 2 <= t ? w0[2] : 0.f, s0 + 3 <= t ? w0[3] : 0.f);
        pw.z = cvtpk(s0 + 4 <= t ? w1[0] : 0.f, s0 + 5 <= t ? w1[1] : 0.f); pw.w = cvtpk(s0 + 6 <= t ? w1[2] : 0.f, s0 + 7 <= t ? w1[3] : 0.f);
        const bf16x8 wf = __builtin_bit_cast(bf16x8, pw);
#pragma unroll
        for (int cc = 0; cc < 2; ++cc) {
            const MLAS unsigned char* vp = vbase + (cb0 + cc) * 8192 + ks * 16 * 64;
            const s16x4 lo = vtr(vp), hi4 = vtr(vp + 4 * 64);
            acc[cc] = __builtin_amdgcn_mfma_f32_32x32x16_bf16(cat8(lo, hi4), wf, acc[cc], 0, 0, 0);
        }
    }
    const float bs = T.b_sp[g * 128 + t];
    const bf16_t* up = T.UZ + (row0 + t) * 1024 + g * 128; bf16_t* yp = T.Y + (row0 + t) * 2048 + g * 128;
#pragma unroll
    for (int cc = 0; cc < 2; ++cc)
#pragma unroll
        for (int rq = 0; rq < 4; ++rq) {
            const int c0 = (cb0 + cc) * 32 + 8 * rq + 4 * hi;
            const u32x2 uz = *(const u32x2*)(up + c0);
            u32x2 o; o.x = cvtpk((acc[cc][4 * rq + 0] + bs) * bflo(uz.x), (acc[cc][4 * rq + 1] + bs) * bfhi(uz.x)); o.y = cvtpk((acc[cc][4 * rq + 2] + bs) * bflo(uz.y), (acc[cc][4 * rq + 3] + bs) * bfhi(uz.y));
            *(u32x2*)(yp + c0) = o;
        }
    __syncthreads();
}
#undef MLAS
}

constexpr int NWAVES = 8;
#ifndef MK_N_LAUNCHES
#define MK_N_LAUNCHES 1
#endif
constexpr int N_PHASES = 5;
constexpr int N_LAUNCHES = MK_N_LAUNCHES;
static_assert(N_LAUNCHES == 1 || N_LAUNCHES == N_PHASES, "MK_N_LAUNCHES is 1 or 5");

constexpr size_t MiB = 1u << 20;
constexpr size_t WS_CTL = 0, CTL_ZERO_BYTES = 1 * MiB;
constexpr size_t WS_WIN = 2 * MiB;
constexpr size_t WS_WOUT = 24 * MiB;
constexpr size_t WS_XN = 32 * MiB;
constexpr size_t WS_UZ = 96 * MiB, WS_V = 128 * MiB, WS_Q = 160 * MiB;
constexpr size_t WS_K = 192 * MiB, WS_VA = 196 * MiB;
constexpr size_t WS_ZB = 200 * MiB;
constexpr size_t WS_Y = 232 * MiB;
constexpr size_t WS_CS = 296 * MiB;
constexpr size_t WS_VSTAT = 300 * MiB;
constexpr size_t WS_SS = 302 * MiB;
constexpr size_t WS_END = 304 * MiB;
constexpr int CW_BAR = 4096;

constexpr int RING_OFF = 0, RING_BYTES = 131072;
constexpr int LDSCTL_OFF = RING_BYTES, MISC_OFF = LDSCTL_OFF + 320;
constexpr int LDS_BYTES = 147456;
static_assert(MISC_OFF + 128 <= LDS_BYTES, "LDS map");

#define GAS __attribute__((address_space(1)))
#define LAS __attribute__((address_space(3)))
typedef unsigned short bf16;
typedef unsigned v4u __attribute__((ext_vector_type(4)));
typedef float f32x4 __attribute__((ext_vector_type(4)));
typedef short bf16x8 __attribute__((ext_vector_type(8)));
typedef GAS unsigned gu32;
typedef GAS unsigned long long gu64;
#define RLX_AGENT __ATOMIC_RELAXED, __HIP_MEMORY_SCOPE_AGENT
#define LDS_WAIT() asm volatile("s_waitcnt lgkmcnt(0)" ::: "memory")
#define VM_WAIT() asm volatile("s_waitcnt vmcnt(0)" ::: "memory")
__device__ __forceinline__ unsigned long long rt() { return __builtin_amdgcn_s_memrealtime(); }
__device__ __forceinline__ unsigned f2bf(float f) { unsigned u = __builtin_bit_cast(unsigned, f); return (u + 0x7fffu + ((u >> 16) & 1u)) >> 16; }
__device__ __forceinline__ unsigned pk2(float lo, float hi) { return f2bf(lo) | (f2bf(hi) << 16); }

#define XB_TMO      128
#define XB_XCNT(j)  (256  + 64 * (j))
#define XB_XSUB(j)  (1280 + 64 * (j))
#define XB_XGEN(j)  (2304 + 64 * (j))
#define XB_TOP      3328
#define XB_TOPGEN   3392
#define XCD_BAR_WORDS 3456
#define XB_SPIN_CAP (1u << 18)

__device__ __forceinline__ unsigned xb_ld(unsigned* p)              { return __hip_atomic_load(p, __ATOMIC_RELAXED, __HIP_MEMORY_SCOPE_AGENT); }
__device__ __forceinline__ unsigned xb_add(unsigned* p, unsigned v) { return __hip_atomic_fetch_add(p, v, __ATOMIC_RELAXED, __HIP_MEMORY_SCOPE_AGENT); }
__device__ __forceinline__ unsigned xb_xcc_id() { return (unsigned)__builtin_amdgcn_s_getreg((3 << 11) | 20) & 0xFu; }
#define XB_SPIN(cond, bar) do { unsigned _sp = 0; while (cond) { __builtin_amdgcn_s_sleep(1); \
    if ((++_sp & 255u) == 0u) { if (xb_ld(&(bar)[XB_TMO])) break; if (_sp > XB_SPIN_CAP) { atomicAdd(&(bar)[XB_TMO], 1u); break; } } } } while (0)

struct XcdBarrier {
    unsigned* bar; unsigned x;
    volatile LAS unsigned* st;
};

__device__ __forceinline__ XcdBarrier xcd_barrier_post(unsigned* bar, volatile LAS unsigned* st) {
    XcdBarrier b; b.bar = bar; b.x = xb_xcc_id(); b.st = st;
    if (threadIdx.x == 0) (void)xb_add(&bar[XB_XCNT(b.x)], 1u);
    return b;
}
__device__ __forceinline__ void xcd_barrier_complete(unsigned* bar, unsigned x, unsigned& nloc, unsigned& nx) {
    const unsigned G = gridDim.x * gridDim.y * gridDim.z;
    unsigned sum, cnt, mine, sp = 0u;
    for (;;) {
        sum = 0u; cnt = 0u; mine = 0u;
#pragma unroll
        for (unsigned j = 0; j < 16; ++j) { const unsigned c = xb_ld(&bar[XB_XCNT(j)]); sum += c; cnt += (c > 0u) ? 1u : 0u; mine = (j == x) ? c : mine; }
        if (sum == G) break;
        __builtin_amdgcn_s_sleep(1);
        if ((++sp & 255u) == 0u) { if (xb_ld(&bar[XB_TMO])) break; if (sp > XB_SPIN_CAP) { atomicAdd(&bar[XB_TMO], 1u); break; } }
    }
    nloc = mine > 0u ? mine : 1u; nx = cnt > 0u ? cnt : 1u;
}

__device__ __forceinline__ void xcd_barrier(const XcdBarrier& b) {
    asm volatile("s_waitcnt vmcnt(0)" ::: "memory");
    __syncthreads();
    if (threadIdx.x == 0) {
        unsigned* bar = b.bar;
        __builtin_amdgcn_s_waitcnt(0);
        unsigned nloc = b.st[0], nx = b.st[1];
        if (nloc == 0u) { xcd_barrier_complete(bar, b.x, nloc, nx); b.st[0] = nloc; b.st[1] = nx; }
        const unsigned old = xb_add(&bar[XB_XSUB(b.x)], 1u);
        const unsigned gen = old / nloc;
        if (old + 1u == (gen + 1u) * nloc) {
            __builtin_amdgcn_fence(__ATOMIC_RELEASE, "agent");
            asm volatile("s_waitcnt vmcnt(0)" ::: "memory");
            const unsigned og = xb_add(&bar[XB_TOP], 1u);
            const unsigned tg = og / nx;
            if (og + 1u == (tg + 1u) * nx) xb_add(&bar[XB_TOPGEN], 1u);
            else XB_SPIN(xb_ld(&bar[XB_TOPGEN]) == tg, bar);
            __builtin_amdgcn_fence(__ATOMIC_ACQUIRE, "agent");
            xb_add(&bar[XB_XGEN(b.x)], 1u);
            asm volatile("s_waitcnt vmcnt(0)" ::: "memory");
        } else {
            XB_SPIN(xb_ld(&bar[XB_XGEN(b.x)]) == gen, bar);
            __builtin_amdgcn_fence(__ATOMIC_ACQUIRE, "agent");
            asm volatile("s_waitcnt vmcnt(0)" ::: "memory");
        }
    }
    __syncthreads();
}

struct Frame {
    LAS unsigned char* lds;
    volatile LAS unsigned* MISC;
    gu32* ctl;
    int tid, lane, wave;
    int vcu, G;
};
__device__ __forceinline__ float wave_sum(float v) {
#pragma unroll
    for (int o = 1; o < 64; o <<= 1) v += __shfl_xor(v, o);
    return v;
}
__device__ __forceinline__ void p0_transpose_item(const float* W, int K, int N, bf16* WT, int k0, int n0, int ncol0, LAS float* scr, int lane) {
#pragma unroll 8
    for (int i = 0; i < 32; ++i) { const int kk = 2 * i + (lane >> 5); scr[kk * 33 + (lane & 31)] = W[(size_t)(k0 + kk) * N + ncol0 + (lane & 31)]; }
    LDS_WAIT(); asm volatile("" ::: "memory");
    const int c = lane & 7;
#pragma unroll
    for (int j = 0; j < 4; ++j) { const int n = (lane >> 3) + 8 * j; const LAS float* s = scr + (8 * c) * 33 + n;
        v4u o; o.x = pk2(s[0 * 33], s[1 * 33]); o.y = pk2(s[2 * 33], s[3 * 33]); o.z = pk2(s[4 * 33], s[5 * 33]); o.w = pk2(s[6 * 33], s[7 * 33]);
        *(GAS v4u*)(WT + (size_t)(n0 + n) * K + k0 + 8 * c) = o; }
    LDS_WAIT(); asm volatile("" ::: "memory");
}
struct Args { const float* in[12]; float* out; unsigned char* ws; int ph_lo, ph_hi, li, pad; };

__device__ __forceinline__ void p0_prologue(Frame& F, const Args& args) {
    const float* x = args.in[0]; const int* positions = (const int*)args.in[1]; const float* g_pre = args.in[2]; const float* w_in = args.in[3]; const float* w_out = args.in[10];
    bf16* WIN = (bf16*)(args.ws + WS_WIN); bf16* WOUT = (bf16*)(args.ws + WS_WOUT); bf16* XN = (bf16*)(args.ws + WS_XN); float* CS = (float*)(args.ws + WS_CS);
    LAS float* scr = (LAS float*)(F.lds + RING_OFF + F.wave * 16384);
    const int gw = F.vcu * NWAVES + F.wave, NGW = F.G * NWAVES;
    constexpr int NB_IN = NPROJ / 32, I_IN = (DM / 64) * NB_IN, NB_OUT = DM / 32, I_OUT = (DM / 64) * NB_OUT;
    for (int it = gw; it < I_IN + I_OUT; it += NGW) {
        if (it < I_IN) { const int kb = it / NB_IN, nb = it % NB_IN; p0_transpose_item(w_in, DM, NPROJ, WIN, 64 * kb, 32 * nb, sigma32(nb), scr, F.lane); }
        else { const int r = it - I_IN, kb = r / NB_OUT, nb = r % NB_OUT; p0_transpose_item(w_out, DM, DM, WOUT, 64 * kb, 32 * nb, 32 * nb, scr, F.lane); }
    }
    { const int i = F.lane & 31; const float inv_freq = (float)pow(10000.0, -(double)i / 32.0);
      for (int it = gw; it < M / 2; it += NGW) { const int row = 2 * it + (F.lane >> 5); const float ang = (float)positions[row] * inv_freq; float sn, cs_; sincosf(ang, &sn, &cs_); CS[(size_t)row * 64 + i] = cs_; CS[(size_t)row * 64 + 32 + i] = sn; } }
    for (int m = gw; m < M; m += NGW) {
        const GAS f32x4* xr = (const GAS f32x4*)(x + (size_t)m * DM) + F.lane; const GAS f32x4* gr = (const GAS f32x4*)g_pre + F.lane;
        f32x4 v[8]; float s = 0.f;
#pragma unroll
        for (int j = 0; j < 8; ++j) { v[j] = xr[64 * j]; s += (v[j].x * v[j].x + v[j].y * v[j].y) + (v[j].z * v[j].z + v[j].w * v[j].w); }
        const float rstd = 1.f / sqrtf(wave_sum(s) * (1.f / DM) + NORM_EPS);
        GAS unsigned long long* o8 = (GAS unsigned long long*)(XN + (size_t)m * DM) + F.lane;
#pragma unroll
        for (int j = 0; j < 8; ++j) { const f32x4 g = gr[64 * j]; o8[64 * j] = (unsigned long long)pk2(v[j].x * rstd * g.x, v[j].y * rstd * g.y) | ((unsigned long long)pk2(v[j].z * rstd * g.z, v[j].w * rstd * g.w) << 32); }
    }
}
__device__ __forceinline__ void p4_final(Frame& F, const Args& args) {
    const float* x = args.in[0]; const float* g_post = args.in[11]; float* out = args.out; const float* SS = (const float*)(args.ws + WS_SS);
    const int gw = F.vcu * NWAVES + F.wave, NGW = F.G * NWAVES;
    for (int m = gw; m < M; m += NGW) {
        const float q = wave_sum(SS[(size_t)m * 32 + (F.lane & 31)]) * 0.5f;
        const float rstd = 1.f / sqrtf(q * (1.f / DM) + NORM_EPS);
        const GAS f32x4* xr = (const GAS f32x4*)(x + (size_t)m * DM) + F.lane; const GAS f32x4* gr = (const GAS f32x4*)g_post + F.lane; GAS f32x4* yr = (GAS f32x4*)(out + (size_t)m * DM) + F.lane;
#pragma unroll
        for (int j = 0; j < 8; ++j) { const f32x4 y = yr[64 * j], g = gr[64 * j], xx = xr[64 * j]; yr[64 * j] = xx + y * rstd * g; }
    }
}

__global__ void __launch_bounds__(NWAVES * 64, 2) mega_fwd(Args args) {
    extern __shared__ __attribute__((aligned(16))) unsigned char lds[];
    Frame F;
    F.lds = (LAS unsigned char*)lds;
    F.MISC = (volatile LAS unsigned*)(F.lds + MISC_OFF);
    F.tid = threadIdx.x; F.lane = F.tid & 63; F.wave = __builtin_amdgcn_readfirstlane(F.tid >> 6);
    F.G = gridDim.x; { const int bx = blockIdx.x; F.vcu = (F.G % 8 == 0) ? (bx % 8) * (F.G / 8) + bx / 8 : bx; }
    unsigned char* ws = args.ws;
    F.ctl = (gu32*)(ws + WS_CTL);
    for (int u = F.tid; u < (LDS_BYTES - LDSCTL_OFF) / 4; u += NWAVES * 64) ((LAS unsigned*)(F.lds + LDSCTL_OFF))[u] = 0u;
    __syncthreads();
    XcdBarrier bar; bar.bar = (unsigned*)(F.ctl + CW_BAR); bar.x = 0; bar.st = nullptr;
    if (N_LAUNCHES == 1) bar = xcd_barrier_post((unsigned*)(F.ctl + CW_BAR), F.MISC + 8);
#define GRID_BAR() do { if (N_LAUNCHES == 1) xcd_barrier(bar); } while (0)
    const int lo = args.ph_lo, hi = args.ph_hi;
#define IN(k) (lo <= (k) && (k) < hi)
    bf16* WIN = (bf16*)(ws + WS_WIN); bf16* WOUT = (bf16*)(ws + WS_WOUT); bf16* XN = (bf16*)(ws + WS_XN);
    bf16 *UZ = (bf16*)(ws + WS_UZ), *VB = (bf16*)(ws + WS_V), *QB = (bf16*)(ws + WS_Q), *KB = (bf16*)(ws + WS_K), *VAB = (bf16*)(ws + WS_VA), *ZB = (bf16*)(ws + WS_ZB), *YB = (bf16*)(ws + WS_Y);
    float* CS = (float*)(ws + WS_CS); float* VSTAT = (float*)(ws + WS_VSTAT); float* SS = (float*)(ws + WS_SS);

    if (IN(0)) { p0_prologue(F, args); GRID_BAR(); }
    if (IN(1)) {
        pg8::Gemm g{XN, WIN, M, NPROJ, DM}; pg8::StaticOrder S; S.init(M, NPROJ, F.G, (int)blockIdx.x);
        pg8::EpiProj E{UZ, VB, QB, KB, VAB, ZB, VSTAT, args.in[4], CS};
        pg8::gemm_phase<pg8::EpiProj, pg8::StaticOrder, PG8_ALIGN, PG8_SP2>(F.lds + RING_OFF, g, S, E);
        GRID_BAR();
    }
    if (IN(2)) {
        const mix::MixT T{UZ, VB, QB, KB, VAB, ZB, YB, VSTAT, args.in[5], args.in[6], args.in[7], args.in[8], args.in[9]};
        for (int it = F.vcu; it < BATCH * 2 * 32; it += F.G) mix::attn_item(T, it >> 6, (it >> 5) & 1, it & 31, F.lds + RING_OFF);
        for (int it = F.vcu; it < BATCH * 32 * 8; it += F.G) mix::gmlp_item(T, it >> 8, (it >> 3) & 31, it & 7, F.lds + RING_OFF);
        GRID_BAR();
    }
    if (IN(3)) {
        pg8::Gemm g{YB, WOUT, M, DM, DM}; pg8::StaticOrder S; S.init(M, DM, F.G, (int)blockIdx.x);
        pg8::EpiOutF32 E{args.out, SS};
        pg8::gemm_phase<pg8::EpiOutF32, pg8::StaticOrder, PG8_ALIGN, PG8_SP2>(F.lds + RING_OFF, g, S, E);
        GRID_BAR();
    }
    if (IN(4)) p4_final(F, args);
#undef IN
#undef GRID_BAR
}

extern "C" void kernel_launch(void* const* d_in, const int* in_sizes, int n_in, void* d_out, int out_size, void* d_ws, size_t ws_size, hipStream_t stream) {
    static int grid = 0;
    if (grid == 0) {
        if (n_in != 12 || in_sizes[0] != M * DM || out_size != M * DM || ws_size < WS_END) { fprintf(stderr, "kernel_launch: unexpected shapes (n_in %d, in0 %d, out %d, ws %zu); nothing launched\n", n_in, n_in > 0 ? in_sizes[0] : -1, out_size, ws_size); grid = -1; return; }
        int dev = 0, cus = 0, per_cu = 0;
        if (hipGetDevice(&dev) != hipSuccess || hipDeviceGetAttribute(&cus, hipDeviceAttributeMultiprocessorCount, dev) != hipSuccess) { fprintf(stderr, "kernel_launch: device query failed\n"); grid = -1; return; }
        if (hipFuncSetAttribute((const void*)mega_fwd, hipFuncAttributeMaxDynamicSharedMemorySize, LDS_BYTES) != hipSuccess) { fprintf(stderr, "kernel_launch: hipFuncSetAttribute failed\n"); grid = -1; return; }
        if (hipOccupancyMaxActiveBlocksPerMultiprocessor(&per_cu, (const void*)mega_fwd, NWAVES * 64, LDS_BYTES) != hipSuccess || per_cu < 1)
            fprintf(stderr, "kernel_launch: note: occupancy query reports %d workgroups per CU\n", per_cu);
        (void)hipGetLastError();
        grid = cus;
    }
    if (grid < 0) return;
    if (hipMemsetAsync((char*)d_ws + WS_CTL, 0, CTL_ZERO_BYTES, stream) != hipSuccess) { fprintf(stderr, "kernel_launch: hipMemsetAsync failed\n"); return; }
    Args a{};
    for (int i = 0; i < 12; ++i) a.in[i] = (const float*)d_in[i];
    a.out = (float*)d_out; a.ws = (unsigned char*)d_ws;
    for (int li = 0; li < N_LAUNCHES; ++li) {
        a.ph_lo = (N_LAUNCHES == 1) ? 0 : li; a.ph_hi = (N_LAUNCHES == 1) ? N_PHASES : li + 1; a.li = li;
        hipLaunchKernelGGL(mega_fwd, dim3(grid), dim3(NWAVES * 64), LDS_BYTES, stream, a);
        const hipError_t le = hipPeekAtLastError();
        if (le != hipSuccess) { fprintf(stderr, "kernel_launch: launch %d failed: %s\n", li, hipGetErrorName(le)); break; }
    }
}
```
